# Optimizing an MI355X kernel written in HIP

```python
import math
import jax, jax.numpy as jnp
from jax import lax
import numpy as np

D_MODEL = 1024
BATCH = 8
SEQ = 2048
DEPTH = 1

ATTN_WIDTH = D_MODEL // 2
N_ATTN_HEADS = 8
HEAD_DIM = ATTN_WIDTH // N_ATTN_HEADS
LRU_WIDTH = D_MODEL - ATTN_WIDTH
N_LRU_BLOCKS = 8
LRU_BLOCK = LRU_WIDTH // N_LRU_BLOCKS
CONV_WIDTH = 4
LRU_C = 8.0
MOBA_BLOCK = 256
MOBA_TOPK = 3
Q_CHUNK = 16
D_FF = 4 * D_MODEL
IN_WIDTH = 3 * ATTN_WIDTH + 2 * LRU_WIDTH
LN_EPS = 1e-5
DEEPNORM_ALPHA = (2.0 * DEPTH) ** 0.25
DEEPNORM_BETA = (8.0 * DEPTH) ** -0.25
NEG_INF = -1e30

kernel_name = "hymba_moba_rglru_deepnorm_layer"


def layer_norm(x, g, b):
    xf = x.astype(jnp.float32)
    mu = jnp.mean(xf, axis=-1, keepdims=True)
    var = jnp.mean(jnp.square(xf - mu), axis=-1, keepdims=True)
    y = (xf - mu) * lax.rsqrt(var + LN_EPS) * g.astype(jnp.float32) + b.astype(jnp.float32)
    return y.astype(x.dtype)


def alibi_slopes(n_heads):
    h = jnp.arange(1, n_heads + 1, dtype=jnp.float32)
    return jnp.exp2(-8.0 * h / n_heads)


def moba_attention(q, k, v):
    B, S, H, Dh = q.shape
    nb = -(-S // MOBA_BLOCK)
    sp = nb * MOBA_BLOCK
    pad = sp - S

    def prep(t):
        t = jnp.pad(t, ((0, 0), (0, pad), (0, 0), (0, 0)))
        return t.transpose(0, 2, 1, 3)

    q, k, v = prep(q), prep(k), prep(v)
    kb = k.reshape(B, H, nb, MOBA_BLOCK, Dh)
    vb = v.reshape(B, H, nb, MOBA_BLOCK, Dh)
    n_chunks = sp // Q_CHUNK
    topk = min(MOBA_TOPK, nb - 1)
    q_blk = jnp.arange(sp) // MOBA_BLOCK

    if topk > 0:
        k_mean = jnp.mean(kb.astype(jnp.float32), axis=3)
        gate = jnp.einsum('bhtd,bhnd->bhtn', q.astype(jnp.float32), k_mean)
        fully_past = jnp.arange(nb)[None, :] < q_blk[:, None]
        gate = jnp.where(fully_past, gate, NEG_INF)
        _, sel = lax.top_k(gate, topk)
        sel = sel.astype(jnp.int32)
    else:
        sel = jnp.zeros((B, H, sp, 0), jnp.int32)
    sel_c = sel.reshape(B, H, n_chunks, Q_CHUNK, topk).transpose(2, 0, 1, 3, 4)
    q_c = q.reshape(B, H, n_chunks, Q_CHUNK, Dh).transpose(2, 0, 1, 3, 4)

    slopes = alibi_slopes(H)[None, :, None, None]
    bi = jnp.arange(B)[:, None, None, None]
    hi = jnp.arange(H)[None, :, None, None]
    key_off = jnp.arange(MOBA_BLOCK)
    scale = Dh ** -0.5

    def chunk_fn(args):
        c, qc, selc = args
        t = c * Q_CHUNK + jnp.arange(Q_CHUNK)
        own = (c * Q_CHUNK) // MOBA_BLOCK
        k_own = lax.dynamic_index_in_dim(kb, own, axis=2, keepdims=False)
        v_own = lax.dynamic_index_in_dim(vb, own, axis=2, keepdims=False)
        s_own = own * MOBA_BLOCK + key_off
        lo = jnp.einsum('bhqd,bhcd->bhqc', qc, k_own).astype(jnp.float32) * scale
        lo = lo - slopes * (t[:, None] - s_own[None, :])
        lo = jnp.where(s_own[None, :] <= t[:, None], lo, NEG_INF)
        kg = kb[bi, hi, selc]
        vg = vb[bi, hi, selc]
        s_past = selc[..., None] * MOBA_BLOCK + key_off
        lp = jnp.einsum('bhqd,bhqkcd->bhqkc', qc, kg).astype(jnp.float32) * scale
        lp = lp - slopes[..., None] * (t[:, None, None] - s_past)
        lp = jnp.where((selc < own)[..., None], lp, NEG_INF)
        n_past = topk * MOBA_BLOCK
        lp = lp.reshape(B, H, Q_CHUNK, n_past)
        p = jax.nn.softmax(jnp.concatenate([lp, lo], axis=-1), axis=-1).astype(v.dtype)
        out = jnp.einsum('bhqn,bhqnd->bhqd', p[..., :n_past],
                         vg.reshape(B, H, Q_CHUNK, n_past, Dh))
        out = out + jnp.einsum('bhqc,bhcd->bhqd', p[..., n_past:], v_own)
        return out

    out = lax.map(chunk_fn, (jnp.arange(n_chunks, dtype=jnp.int32), q_c, sel_c))
    out = out.transpose(1, 0, 3, 2, 4).reshape(B, sp, H * Dh)
    return out[:, :S]


def causal_depthwise_conv(x, w, b):
    S = x.shape[1]
    xp = jnp.pad(x, ((0, 0), (CONV_WIDTH - 1, 0), (0, 0)))
    y = b
    for kk in range(CONV_WIDTH):
        y = y + xp[:, kk:kk + S] * w[kk]
    return y


def block_diag_linear(x, w, b):
    xb = x.reshape(x.shape[0], x.shape[1], N_LRU_BLOCKS, LRU_BLOCK)
    y = jnp.einsum('bsnd,nde->bsne', xb, w).reshape(x.shape)
    return y + b


def rg_lru(x, w_rg, b_rg, w_ig, b_ig, lam):
    xf = x.astype(jnp.float32)
    r = jax.nn.sigmoid(block_diag_linear(x, w_rg, b_rg).astype(jnp.float32))
    i = jax.nn.sigmoid(block_diag_linear(x, w_ig, b_ig).astype(jnp.float32))
    log_a = -LRU_C * r * jax.nn.softplus(-lam.astype(jnp.float32))
    a = jnp.exp(log_a)
    u = jnp.sqrt(-jnp.expm1(2.0 * log_a)) * (i * xf)

    def combine(left, right):
        a1, b1 = left
        a2, b2 = right
        return a1 * a2, a2 * b1 + b2

    _, h = lax.associative_scan(combine, (a, u), axis=1)
    return h.astype(x.dtype)


def setup_inputs(seed: int = 0) -> dict:
    key = jax.random.key(seed)
    ks = jax.random.split(key, 20)
    f32 = jnp.float32
    L = DEPTH
    w_in = jax.random.normal(ks[1], (L, D_MODEL, IN_WIDTH), f32) * D_MODEL ** -0.5
    w_in = w_in.at[:, :, 2 * ATTN_WIDTH:3 * ATTN_WIDTH].multiply(DEEPNORM_BETA)
    conv_w = jax.random.normal(ks[2], (L, CONV_WIDTH, LRU_WIDTH), f32) * CONV_WIDTH ** -0.5
    conv_b = 0.02 * jax.random.normal(ks[3], (L, LRU_WIDTH), f32)
    w_rg = jax.random.normal(ks[4], (L, N_LRU_BLOCKS, LRU_BLOCK, LRU_BLOCK), f32) * LRU_BLOCK ** -0.5
    b_rg = 0.02 * jax.random.normal(ks[5], (L, LRU_WIDTH), f32)
    w_ig = jax.random.normal(ks[6], (L, N_LRU_BLOCKS, LRU_BLOCK, LRU_BLOCK), f32) * LRU_BLOCK ** -0.5
    b_ig = 0.02 * jax.random.normal(ks[7], (L, LRU_WIDTH), f32)
    a_c = jax.random.uniform(ks[8], (L, LRU_WIDTH), f32, 0.9, 0.999)
    a0 = a_c ** (1.0 / LRU_C)
    lru_lambda = jnp.log(a0) - jnp.log1p(-a0)
    w_out = jax.random.normal(ks[9], (L, D_MODEL, D_MODEL), f32) * D_MODEL ** -0.5 * DEEPNORM_BETA
    ln1_g = 1.0 + 0.02 * jax.random.normal(ks[10], (L, D_MODEL), f32)
    ln1_b = 0.02 * jax.random.normal(ks[11], (L, D_MODEL), f32)
    w_up = jax.random.normal(ks[12], (L, D_MODEL, D_FF), f32) * D_MODEL ** -0.5 * DEEPNORM_BETA
    b_up = 0.02 * jax.random.normal(ks[13], (L, D_FF), f32)
    w_down = jax.random.normal(ks[14], (L, D_FF, D_MODEL), f32) * D_FF ** -0.5 * DEEPNORM_BETA
    b_down = 0.02 * jax.random.normal(ks[15], (L, D_MODEL), f32)
    ln2_g = 1.0 + 0.02 * jax.random.normal(ks[16], (L, D_MODEL), f32)
    ln2_b = 0.02 * jax.random.normal(ks[17], (L, D_MODEL), f32)
    x = jax.random.normal(ks[0], (BATCH, SEQ, D_MODEL), f32)
    return {"x": x, "w_in": w_in, "conv_w": conv_w, "conv_b": conv_b,
            "w_rg": w_rg, "b_rg": b_rg, "w_ig": w_ig, "b_ig": b_ig,
            "lru_lambda": lru_lambda, "w_out": w_out, "ln1_g": ln1_g, "ln1_b": ln1_b,
            "w_up": w_up, "b_up": b_up, "w_down": w_down, "b_down": b_down,
            "ln2_g": ln2_g, "ln2_b": ln2_b}


def reference(x, w_in, conv_w, conv_b, w_rg, b_rg, w_ig, b_ig, lru_lambda, w_out,
              ln1_g, ln1_b, w_up, b_up, w_down, b_down, ln2_g, ln2_b):
    B, S, _ = x.shape
    for l in range(DEPTH):
        proj = jnp.einsum('bsd,de->bse', x, w_in[l])
        q, k, v, xr, gr = jnp.split(
            proj, [ATTN_WIDTH, 2 * ATTN_WIDTH, 3 * ATTN_WIDTH, 3 * ATTN_WIDTH + LRU_WIDTH], axis=-1)
        hs = (B, S, N_ATTN_HEADS, HEAD_DIM)
        attn = moba_attention(q.reshape(hs), k.reshape(hs), v.reshape(hs))
        xr = causal_depthwise_conv(xr, conv_w[l], conv_b[l])
        lru = rg_lru(xr, w_rg[l], b_rg[l], w_ig[l], b_ig[l], lru_lambda[l]) * jax.nn.gelu(gr)
        mix = jnp.einsum('bse,ed->bsd', jnp.concatenate([attn, lru], axis=-1), w_out[l])
        x = layer_norm(DEEPNORM_ALPHA * x + mix, ln1_g[l], ln1_b[l])
        h = jnp.square(jax.nn.relu(jnp.einsum('bsd,df->bsf', x, w_up[l]) + b_up[l]))
        h = jnp.einsum('bsf,fd->bsd', h, w_down[l]) + b_down[l]
        x = layer_norm(DEEPNORM_ALPHA * x + h, ln2_g[l], ln2_b[l])
    return x
```

```cpp
#include <hip/hip_runtime.h>
#include <cstdio>
#include <cstdint>
#include <cmath>

namespace nv {
constexpr int BATCH = 8, SEQ = 2048, DM = 1024, AW = 512, NH = 8, HD = 64, LW = 512, NLB = 8, LB = 64, FF = 4096, INW = 2560, MB = 256;
constexpr int M = BATCH * SEQ, NB = SEQ / MB;
constexpr float ALPHA = 1.189207115002721f;
constexpr float LN_EPS = 1e-5f;

template <int ACT> __global__ __launch_bounds__(256) void gemm_naive(const float* __restrict__ A, int lda, const float* __restrict__ B, int ldb, float* __restrict__ C, int ldc, int K, const float* __restrict__ bias) {
    __shared__ float As[16][68];
    __shared__ float Bs[16][64];
    const int tid = threadIdx.x, tx = tid & 15, ty = tid >> 4;
    const int m0 = blockIdx.y * 64, n0 = blockIdx.x * 64;
    float acc[4][4];
#pragma unroll
    for (int i = 0; i < 4; ++i)
#pragma unroll
        for (int j = 0; j < 4; ++j) acc[i][j] = 0.f;
    for (int k0 = 0; k0 < K; k0 += 16) {
#pragma unroll
        for (int i = 0; i < 4; ++i) { const int idx = tid + 256 * i, r = idx >> 4, c = idx & 15; As[c][r] = A[(size_t)(m0 + r) * lda + k0 + c]; }
#pragma unroll
        for (int i = 0; i < 4; ++i) { const int idx = tid + 256 * i, r = idx >> 6, c = idx & 63; Bs[r][c] = B[(size_t)(k0 + r) * ldb + n0 + c]; }
        __syncthreads();
#pragma unroll
        for (int kk = 0; kk < 16; ++kk) {
            float a[4], b[4];
#pragma unroll
            for (int i = 0; i < 4; ++i) a[i] = As[kk][ty * 4 + i];
#pragma unroll
            for (int j = 0; j < 4; ++j) b[j] = Bs[kk][tx * 4 + j];
#pragma unroll
            for (int i = 0; i < 4; ++i)
#pragma unroll
                for (int j = 0; j < 4; ++j) acc[i][j] = fmaf(a[i], b[j], acc[i][j]);
        }
        __syncthreads();
    }
#pragma unroll
    for (int i = 0; i < 4; ++i)
#pragma unroll
        for (int j = 0; j < 4; ++j) {
            const int col = n0 + tx * 4 + j; float v = acc[i][j] + (bias ? bias[col] : 0.f);
            if (ACT == 1) { v = v > 0.f ? v : 0.f; v = v * v; }
            C[(size_t)(m0 + ty * 4 + i) * ldc + col] = v;
        }
}

__global__ __launch_bounds__(64) void kmean_naive(const float* __restrict__ proj, float* __restrict__ kmean) {
    const int idx = blockIdx.x, n = idx % NB, h = (idx / NB) % NH, b = idx / (NB * NH), d = threadIdx.x;
    float s = 0.f;
    for (int i = 0; i < MB; ++i) s += proj[(size_t)(b * SEQ + n * MB + i) * INW + AW + h * HD + d];
    kmean[(size_t)idx * HD + d] = s * (1.0f / MB);
}

__device__ __forceinline__ float wsum(float v) {
#pragma unroll
    for (int o = 1; o < 64; o <<= 1) v += __shfl_xor(v, o);
    return v;
}
__device__ __forceinline__ float wmax(float v) {
#pragma unroll
    for (int o = 1; o < 64; o <<= 1) v = fmaxf(v, __shfl_xor(v, o));
    return v;
}

__global__ __launch_bounds__(256) void attn_naive(const float* __restrict__ proj, const float* __restrict__ kmean, float* __restrict__ cat) {
    __shared__ float qs[4][64];
    __shared__ float sc[4][1024];
    const int wave = threadIdx.x >> 6, lane = threadIdx.x & 63;
    const int gq = blockIdx.x * 4 + wave;
    const int t = gq % SEQ, bh = gq / SEQ, h = bh % NH, b = bh / NH;
    const int own = t / MB;
    const float qv = proj[(size_t)(b * SEQ + t) * INW + h * HD + lane];
    qs[wave][lane] = qv;
    float gate[NB];
#pragma unroll
    for (int n = 0; n < NB; ++n) {
        const float p = wsum(qv * kmean[(size_t)((b * NH + h) * NB + n) * HD + lane]);
        gate[n] = (n < own) ? p : -1e30f;
    }
    unsigned selmask = 0u;
#pragma unroll
    for (int n = 0; n < NB; ++n) {
        int rank = 0;
#pragma unroll
        for (int m = 0; m < NB; ++m) if (m != n) rank += ((gate[m] > gate[n]) || (gate[m] == gate[n] && m < n)) ? 1 : 0;
        if (n < own && rank < 3) selmask |= 1u << n;
    }
    selmask |= 1u << own;
    __syncthreads();
    const float slope = exp2f(-(float)(h + 1));
    int slot = 0;
    for (int j = 0; j <= own; ++j) {
        if (!((selmask >> j) & 1u)) continue;
        for (int i = 0; i < 4; ++i) {
            const int kk = lane + 64 * i, pos = j * MB + kk;
            const float* kp = proj + (size_t)(b * SEQ + pos) * INW + AW + h * HD;
            float dot = 0.f;
            for (int d = 0; d < HD; ++d) dot = fmaf(qs[wave][d], kp[d], dot);
            float s = dot * 0.125f - slope * (float)(t - pos);
            if (pos > t) s = -1e30f;
            sc[wave][slot * MB + kk] = s;
        }
        ++slot;
    }
    __syncthreads();
    const int nk = slot * MB;
    float mx = -3e38f;
    for (int i = lane; i < nk; i += 64) mx = fmaxf(mx, sc[wave][i]);
    mx = wmax(mx);
    float sum = 0.f;
    for (int i = lane; i < nk; i += 64) { const float e = expf(sc[wave][i] - mx); sc[wave][i] = e; sum += e; }
    sum = wsum(sum);
    __syncthreads();
    float o = 0.f; slot = 0;
    for (int j = 0; j <= own; ++j) {
        if (!((selmask >> j) & 1u)) continue;
        const float* vp = proj + (size_t)(b * SEQ + j * MB) * INW + 2 * AW + h * HD + lane;
        for (int kk = 0; kk < MB; ++kk) o = fmaf(sc[wave][slot * MB + kk], vp[(size_t)kk * INW], o);
        ++slot;
    }
    cat[(size_t)(b * SEQ + t) * DM + h * HD + lane] = o / sum;
}

__global__ __launch_bounds__(64) void lru_gate_naive(const float* __restrict__ proj, const float* __restrict__ conv_w, const float* __restrict__ conv_b, const float* __restrict__ w_rg, const float* __restrict__ b_rg,
                                                     const float* __restrict__ w_ig, const float* __restrict__ b_ig, const float* __restrict__ lam, float* __restrict__ cat, float* __restrict__ ubuf) {
    __shared__ float xs[64];
    const int n = blockIdx.x % NLB, m = blockIdx.x / NLB, t = m % SEQ, lane = threadIdx.x, c = n * LB + lane;
    float xc = conv_b[c];
#pragma unroll
    for (int k = 0; k < 4; ++k) { const int tt = t - 3 + k; if (tt >= 0) xc = fmaf(conv_w[k * LW + c], proj[(size_t)(m - 3 + k) * INW + 3 * AW + c], xc); }
    xs[lane] = xc;
    __syncthreads();
    float pr = b_rg[c], pi = b_ig[c];
    for (int d = 0; d < LB; ++d) { pr = fmaf(xs[d], w_rg[(size_t)(n * LB + d) * LB + lane], pr); pi = fmaf(xs[d], w_ig[(size_t)(n * LB + d) * LB + lane], pi); }
    const float r = 1.f / (1.f + expf(-pr)), ig = 1.f / (1.f + expf(-pi));
    const float l = lam[c], sp = (l > 0.f) ? log1pf(expf(-l)) : (-l + log1pf(expf(l)));
    const float log_a = -8.0f * r * sp;
    const float a = expf(log_a), u = sqrtf(-expm1f(2.f * log_a)) * (ig * xc);
    cat[(size_t)m * DM + AW + c] = a;
    ubuf[(size_t)m * DM + c] = u;
}
__global__ __launch_bounds__(64) void lru_scan_naive(const float* __restrict__ proj, float* __restrict__ cat, const float* __restrict__ ubuf) {
    const int idx = blockIdx.x * 64 + threadIdx.x, c = idx % LW, b = idx / LW;
    float h = 0.f;
    for (int t = 0; t < SEQ; ++t) {
        const size_t m = (size_t)b * SEQ + t;
        const float a = cat[m * DM + AW + c], u = ubuf[m * DM + c], g = proj[m * INW + 3 * AW + LW + c];
        h = fmaf(a, h, u);
        const float z = 0.7978845608028654f * (g + 0.044715f * g * g * g);
        const float ge = 0.5f * g * (1.f + tanhf(z));
        cat[m * DM + AW + c] = h * ge;
    }
}
__global__ __launch_bounds__(256) void ln_naive(const float* res, const float* __restrict__ add, const float* __restrict__ g, const float* __restrict__ bb, float* out, int row0) {
    const int wave = threadIdx.x >> 6, lane = threadIdx.x & 63, row = row0 + blockIdx.x * 4 + wave;
    float v[16]; float s = 0.f;
#pragma unroll
    for (int j = 0; j < 16; ++j) { const int col = lane + 64 * j; v[j] = ALPHA * res[(size_t)row * DM + col] + add[(size_t)(row - row0) * DM + col]; s += v[j]; }
    const float mean = wsum(s) * (1.f / DM); float q = 0.f;
#pragma unroll
    for (int j = 0; j < 16; ++j) { v[j] -= mean; q += v[j] * v[j]; }
    const float rstd = rsqrtf(wsum(q) * (1.f / DM) + LN_EPS);
#pragma unroll
    for (int j = 0; j < 16; ++j) { const int col = lane + 64 * j; out[(size_t)row * DM + col] = v[j] * rstd * g[col] + bb[col]; }
}
}

extern "C" void kernel_launch(void* const* d_in, const int* in_sizes, int n_in, void* d_out, int out_size, void* d_ws, size_t ws_size, hipStream_t stream) {
    using namespace nv;
    const float* x = (const float*)d_in[0]; const float* w_in = (const float*)d_in[1]; const float* conv_w = (const float*)d_in[2]; const float* conv_b = (const float*)d_in[3];
    const float* w_rg = (const float*)d_in[4]; const float* b_rg = (const float*)d_in[5]; const float* w_ig = (const float*)d_in[6]; const float* b_ig = (const float*)d_in[7];
    const float* lam = (const float*)d_in[8]; const float* w_out = (const float*)d_in[9]; const float* ln1_g = (const float*)d_in[10]; const float* ln1_b = (const float*)d_in[11];
    const float* w_up = (const float*)d_in[12]; const float* b_up = (const float*)d_in[13]; const float* w_down = (const float*)d_in[14]; const float* b_down = (const float*)d_in[15];
    const float* ln2_g = (const float*)d_in[16]; const float* ln2_b = (const float*)d_in[17];
    float* out = (float*)d_out; char* ws = (char*)d_ws;
    const size_t MiB = 1u << 20;
    if (n_in != 18 || out_size != M * DM || ws_size < 256 * MiB) { fprintf(stderr, "kernel_launch: unexpected sizes\n"); return; }
    float* proj = (float*)(ws);
    float* kmean = (float*)(ws + 160 * MiB);
    float* cat = (float*)(ws + 162 * MiB);
    float* mix = (float*)(ws);
    float* hbuf = (float*)(ws + 64 * MiB);
    float* ffc = (float*)(ws);
    gemm_naive<0><<<dim3(INW / 64, M / 64), 256, 0, stream>>>(x, DM, w_in, INW, proj, INW, DM, nullptr);
    kmean_naive<<<BATCH * NH * NB, 64, 0, stream>>>(proj, kmean);
    attn_naive<<<BATCH * NH * SEQ / 4, 256, 0, stream>>>(proj, kmean, cat);
    lru_gate_naive<<<M * NLB, 64, 0, stream>>>(proj, conv_w, conv_b, w_rg, b_rg, w_ig, b_ig, lam, cat, out);
    lru_scan_naive<<<BATCH * LW / 64, 64, 0, stream>>>(proj, cat, out);
    gemm_naive<0><<<dim3(DM / 64, M / 64), 256, 0, stream>>>(cat, DM, w_out, DM, mix, DM, DM, nullptr);
    ln_naive<<<M / 4, 256, 0, stream>>>(x, mix, ln1_g, ln1_b, out, 0);
    for (int ch = 0; ch < 4; ++ch) {
        const int r0 = ch * 4096;
        gemm_naive<1><<<dim3(FF / 64, 4096 / 64), 256, 0, stream>>>(out + (size_t)r0 * DM, DM, w_up, FF, hbuf, FF, DM, b_up);
        gemm_naive<0><<<dim3(DM / 64, 4096 / 64), 256, 0, stream>>>(hbuf, FF, w_down, DM, ffc, DM, FF, b_down);
        ln_naive<<<4096 / 4, 256, 0, stream>>>(out, ffc, ln2_g, ln2_b, out, r0);
    }
}
```
